# Optimizing an MI355X kernel written in HIP

```python
import jax, jax.numpy as jnp
from jax import lax
import numpy as np

D_MODEL = 1024
BATCH = 4
SEQ = 4096
DEPTH = 1

CONV_WIDTH = 512
CONV_GROUPS = 8
CONV_K = 3
GLA_HEADS = 4
GLA_DK = 64
GLA_DV = 128
GLA_KEY_WIDTH = GLA_HEADS * GLA_DK
GLA_VAL_WIDTH = GLA_HEADS * GLA_DV
GATE_RANK = 16
GATE_NORMALIZER = 16.0
CHUNK = 64
MIX_WIDTH = CONV_WIDTH + GLA_VAL_WIDTH
IN_SIZES = [CONV_WIDTH, CONV_WIDTH, CONV_WIDTH,
            GLA_KEY_WIDTH, GLA_KEY_WIDTH, GLA_VAL_WIDTH,
            GLA_VAL_WIDTH, GATE_RANK]
IN_COLS = sum(IN_SIZES)
IN_SPLITS = np.cumsum(IN_SIZES)[:-1].tolist()
D_FF = 2816
N_ADA = 9
EPS = 1e-6

kernel_name = "hybrid_conv_gla_macaron_adaln"


def rms_norm(x, gain):
    xf = x.astype(jnp.float32)
    y = xf * lax.rsqrt(jnp.mean(xf * xf, axis=-1, keepdims=True) + EPS)
    return (y * gain.astype(jnp.float32)).astype(x.dtype)


def modulate(h, shift, scale):
    return h * (1.0 + scale[:, None, :]) + shift[:, None, :]


def swiglu_ffn(h, w_in, w_out):
    gate, up = jnp.split(h @ w_in, 2, axis=-1)
    return (jax.nn.silu(gate) * up) @ w_out


def causal_short_conv(u, w):
    T = u.shape[1]
    up = jnp.pad(u, ((0, 0), (CONV_K - 1, 0), (0, 0)))
    y = up[:, 0:T, :] * w[0]
    for k in range(1, CONV_K):
        y = y + up[:, k:k + T, :] * w[k]
    return y


def gla_chunked(q, k, v, log_g):
    B, H, T, DK = q.shape
    DV = v.shape[-1]
    N = T // CHUNK

    def to_chunks(a):
        return a.reshape(B, H, N, CHUNK, a.shape[-1]).transpose(2, 0, 1, 3, 4)

    qc, kc, vc, gc = to_chunks(q), to_chunks(k), to_chunks(v), to_chunks(log_g)
    bc = jnp.cumsum(gc, axis=3)
    causal = jnp.tril(jnp.ones((CHUNK, CHUNK), dtype=bool))[:, :, None]

    def step(S, inp):
        q_, k_, v_, b_ = inp
        o_inter = jnp.einsum('bhik,bhkv->bhiv', q_ * jnp.exp(b_), S)
        rel = b_[:, :, :, None, :] - b_[:, :, None, :, :]
        decay = jnp.where(causal, jnp.exp(jnp.where(causal, rel, 0.0)), 0.0)
        scores = jnp.einsum('bhik,bhijk,bhjk->bhij', q_, decay, k_)
        o_intra = jnp.einsum('bhij,bhjv->bhiv', scores, v_)
        b_last = b_[:, :, -1:, :]
        S_new = (jnp.exp(b_last[:, :, 0, :])[..., None] * S
                 + jnp.einsum('bhjk,bhjv->bhkv', k_ * jnp.exp(b_last - b_), v_))
        return S_new, o_inter + o_intra

    S0 = jnp.zeros((B, H, DK, DV), jnp.float32)
    _, o = lax.scan(step, S0, (qc, kc, vc, bc))
    return o.transpose(1, 2, 0, 3, 4).reshape(B, H, T, DV)


def token_mixer(h, w_in, conv_w, w_gk2, b_gk, gla_norm, w_out):
    Bsz, T, _ = h.shape
    proj = h @ w_in
    cb, cc, cv, q, k, v, g_out, gk_low = jnp.split(proj, IN_SPLITS, axis=-1)
    y_conv = cb * causal_short_conv(cc * cv, conv_w)
    log_g = jax.nn.log_sigmoid((gk_low @ w_gk2 + b_gk).astype(jnp.float32)) / GATE_NORMALIZER

    def heads(a, d):
        return a.reshape(Bsz, T, GLA_HEADS, d).transpose(0, 2, 1, 3).astype(jnp.float32)

    o = gla_chunked(heads(q, GLA_DK) * (GLA_DK ** -0.5), heads(k, GLA_DK),
                    heads(v, GLA_DV), heads(log_g, GLA_DK))
    o = rms_norm(o, gla_norm)
    o = o.transpose(0, 2, 1, 3).reshape(Bsz, T, GLA_VAL_WIDTH).astype(h.dtype)
    y_gla = o * jax.nn.silu(g_out)
    return jnp.concatenate([y_conv, y_gla], axis=-1) @ w_out


def setup_inputs(seed: int = 0) -> dict:
    key = jax.random.key(seed)
    ks = jax.random.split(key, 20)
    f32 = jnp.float32
    nrm = lambda k, shape, s: jax.random.normal(k, shape, f32) * s
    L, D = DEPTH, D_MODEL
    return {
        "x": nrm(ks[0], (BATCH, SEQ, D), 1.0),
        "c": nrm(ks[1], (BATCH, D), 1.0),
        "w_ada": nrm(ks[2], (L, D, N_ADA * D), 0.5 * D ** -0.5),
        "b_ada": nrm(ks[3], (L, N_ADA * D), 0.01),
        "norm_ffn1": 1.0 + nrm(ks[4], (L, D), 0.02),
        "w_ffn1_in": nrm(ks[5], (L, D, 2 * D_FF), D ** -0.5),
        "w_ffn1_out": nrm(ks[6], (L, D_FF, D), D_FF ** -0.5),
        "norm_mix": 1.0 + nrm(ks[7], (L, D), 0.02),
        "w_mix_in": nrm(ks[8], (L, D, IN_COLS), D ** -0.5),
        "conv_w": nrm(ks[9], (L, CONV_K, CONV_WIDTH), CONV_K ** -0.5),
        "w_gk2": nrm(ks[10], (L, GATE_RANK, GLA_KEY_WIDTH), GATE_RANK ** -0.5),
        "b_gk": nrm(ks[11], (L, GLA_KEY_WIDTH), 0.01),
        "gla_norm": 1.0 + nrm(ks[12], (L, GLA_DV), 0.02),
        "w_mix_out": nrm(ks[13], (L, MIX_WIDTH, D), MIX_WIDTH ** -0.5),
        "norm_ffn2": 1.0 + nrm(ks[14], (L, D), 0.02),
        "w_ffn2_in": nrm(ks[15], (L, D, 2 * D_FF), D ** -0.5),
        "w_ffn2_out": nrm(ks[16], (L, D_FF, D), D_FF ** -0.5),
        "norm_final": 1.0 + nrm(ks[17], (D,), 0.02),
    }


def reference(x, c, w_ada, b_ada, norm_ffn1, w_ffn1_in, w_ffn1_out, norm_mix,
              w_mix_in, conv_w, w_gk2, b_gk, gla_norm, w_mix_out, norm_ffn2,
              w_ffn2_in, w_ffn2_out, norm_final):
    c_act = jax.nn.silu(c)
    for l in range(DEPTH):
        ada = c_act @ w_ada[l] + b_ada[l]
        sh1, sc1, g1, sh2, sc2, g2, sh3, sc3, g3 = jnp.split(ada, N_ADA, axis=-1)
        h = modulate(rms_norm(x, norm_ffn1[l]), sh1, sc1)
        x = x + 0.5 * g1[:, None, :] * swiglu_ffn(h, w_ffn1_in[l], w_ffn1_out[l])
        h = modulate(rms_norm(x, norm_mix[l]), sh2, sc2)
        x = x + g2[:, None, :] * token_mixer(h, w_mix_in[l], conv_w[l], w_gk2[l],
                                             b_gk[l], gla_norm[l], w_mix_out[l])
        h = modulate(rms_norm(x, norm_ffn2[l]), sh3, sc3)
        x = x + 0.5 * g3[:, None, :] * swiglu_ffn(h, w_ffn2_in[l], w_ffn2_out[l])
    return rms_norm(x, norm_final)
```

```cpp
#include <hip/hip_runtime.h>
#include <cstdio>
#include <cstdint>
#include <cmath>
namespace pg8 {
#define PG8_LAS __attribute__((address_space(3)))
typedef unsigned short bf16_t;
typedef short bf16x8 __attribute__((ext_vector_type(8)));
typedef float f32x4 __attribute__((ext_vector_type(4)));
typedef unsigned u32x4 __attribute__((ext_vector_type(4)));
constexpr int BM = 256, BK = 64, HALF = 128, HTB = HALF * BK * 2  , STAGE_BYTES = 8 * HTB, NXCD = 8, WGM = 8;

__host__ __device__ __forceinline__ int lds_byte(int r, int c) { const int st = (r >> 4) * 2 + (c >> 5), rr = r & 15, cc = c & 31, ob = rr * 64 + cc * 2; return st * 1024 + (ob ^ (((ob >> 9) & 1) << 5)); }
__host__ __device__ __forceinline__ void stage_rc(int b, int& R, int& C) { const int st = b / 1024, sb = b % 1024, swz = sb ^ (((sb >> 9) & 1) << 5); R = (st >> 1) * 16 + swz / 64; C = (st & 1) * 32 + (swz % 64) / 2; }
__host__ __device__ __forceinline__ int perm32(int rho) { const int n = rho >> 4, i = rho & 15; return 8 * (i >> 2) + 4 * n + (i & 3); }

struct Unit { int pm, pn; };
struct Gemm { const bf16_t* A; const bf16_t* Bt; int M, N, K; };

struct StaticOrder {
    int nM, nN, nwg, G, c;
    __host__ __device__ void init(int M, int N, int G_, int c_) { nM = M / BM; nN = N / BM; nwg = nM * nN; G = G_; c = c_; }
    __host__ __device__ bool next(int i, Unit& u) const {
        const long L = (long)i * G + c; if (L >= nwg) return false;
        int wgid = (int)L; { const int q = nwg / NXCD, r = nwg % NXCD, xcd = wgid % NXCD, off = wgid / NXCD; wgid = (xcd < r ? xcd * (q + 1) : r * (q + 1) + (xcd - r) * q) + off; }
        const int nig = WGM * nN, gid = wgid / nig, fm = gid * WGM, gsz = (nM - fm) < WGM ? (nM - fm) : WGM;
        u.pm = fm + ((wgid % nig) % gsz); u.pn = (wgid % nig) / gsz; return true;
    }
    __device__ __forceinline__ void a_ready(const Unit&) const {}
    __device__ __forceinline__ void done(const Unit&) const {}
};


__device__ __forceinline__ unsigned cvt_pk_bf16(float lo, float hi) { unsigned r; asm volatile("v_cvt_pk_bf16_f32 %0, %1, %2" : "=v"(r) : "v"(lo), "v"(hi)); return r; }
__device__ __forceinline__ float silu_f(float g) { return g * __builtin_amdgcn_rcpf(1.0f + __builtin_amdgcn_exp2f(-1.44269504089f * g)); }

template <int ACT> __device__ __forceinline__ void epi_pair_store(const f32x4 (&acc)[2][2][4][2], bf16_t* O, int ldo, int row0, int col0) {
#pragma unroll
    for (int ai = 0; ai < 2; ++ai)
#pragma unroll
        for (int m = 0; m < 4; ++m) {
            bf16_t* rowp = O + (size_t)(row0 + ai * HALF + m * 16) * ldo + col0;
            const f32x4 g0 = acc[ai][0][m][0], g1 = acc[ai][0][m][1], u0 = acc[ai][1][m][0], u1 = acc[ai][1][m][1];
            f32x4 v0, v1;
#pragma unroll
            for (int e = 0; e < 4; ++e) { v0[e] = (ACT ? silu_f(g0[e]) : g0[e]) * u0[e]; v1[e] = (ACT ? silu_f(g1[e]) : g1[e]) * u1[e]; }
            u32x4 w; w.x = cvt_pk_bf16(v0[0], v0[1]); w.y = cvt_pk_bf16(v0[2], v0[3]); w.z = cvt_pk_bf16(v1[0], v1[1]); w.w = cvt_pk_bf16(v1[2], v1[3]);
            *(u32x4*)rowp = w;
        }
}
__device__ __forceinline__ void epi_plain_store(const f32x4 (&acc)[2][2][4][2], bf16_t* O, int ldo, int row0, int col0) {
#pragma unroll
    for (int ai = 0; ai < 2; ++ai)
#pragma unroll
        for (int m = 0; m < 4; ++m) {
            bf16_t* rowp = O + (size_t)(row0 + ai * HALF + m * 16) * ldo + col0;
#pragma unroll
            for (int bj = 0; bj < 2; ++bj) {
                const f32x4 v0 = acc[ai][bj][m][0], v1 = acc[ai][bj][m][1];
                u32x4 w; w.x = cvt_pk_bf16(v0[0], v0[1]); w.y = cvt_pk_bf16(v0[2], v0[3]); w.z = cvt_pk_bf16(v1[0], v1[1]); w.w = cvt_pk_bf16(v1[2], v1[3]);
                *(u32x4*)(rowp + bj * HALF) = w;
            }
        }
}
struct EpiSwiglu {
    static constexpr bool PERM = true, AFTER_DRAIN = false;
    bf16_t* O; int ldo;
    __device__ __forceinline__ void operator()(const f32x4 (&acc)[2][2][4][2], const Unit& u, int wr, int wc, int fr, int fq) const {
        epi_pair_store<1>(acc, O, ldo, u.pm * BM + wr * 64 + fr, u.pn * 128 + wc * 32 + 8 * fq);
    }
};
struct EpiMix {
    static constexpr bool PERM = true, AFTER_DRAIN = false;
    bf16_t *CB, *U, *QKVG;
    __device__ __forceinline__ void operator()(const f32x4 (&acc)[2][2][4][2], const Unit& u, int wr, int wc, int fr, int fq) const {
        const int row0 = u.pm * BM + wr * 64 + fr, cin = wc * 32 + 8 * fq;
        if (u.pn < 2) epi_plain_store(acc, CB, 512, row0, u.pn * 256 + cin);
        else if (u.pn < 6) epi_pair_store<0>(acc, U, 512, row0, (u.pn - 2) * 128 + cin);
        else epi_plain_store(acc, QKVG, 1536, row0, (u.pn - 6) * 256 + cin);
    }
};
struct EpiRes {
    static constexpr bool PERM = false, AFTER_DRAIN = false;
    const float* base; float* out; const float* gate; int gate_ld; float scale;
    __device__ __forceinline__ void operator()(const f32x4 (&acc)[2][2][4][2], const Unit& u, int wr, int wc, int fr, int fq) const {
        const int row0 = u.pm * BM + wr * 64 + fr, col0 = u.pn * BM + wc * 32 + 4 * fq;
        const float* gp = gate + (size_t)(u.pm >> 4) * gate_ld + col0;
        f32x4 gv[2][2];
#pragma unroll
        for (int bj = 0; bj < 2; ++bj)
#pragma unroll
            for (int n = 0; n < 2; ++n) gv[bj][n] = *(const f32x4*)(gp + bj * HALF + n * 16) * scale;
#pragma unroll
        for (int ai = 0; ai < 2; ++ai)
#pragma unroll
            for (int m = 0; m < 4; ++m) {
                const size_t off = (size_t)(row0 + ai * HALF + m * 16) * 1024 + col0;
                f32x4 bs[2][2];
#pragma unroll
                for (int bj = 0; bj < 2; ++bj)
#pragma unroll
                    for (int n = 0; n < 2; ++n) bs[bj][n] = *(const f32x4*)(base + off + bj * HALF + n * 16);
#pragma unroll
                for (int bj = 0; bj < 2; ++bj)
#pragma unroll
                    for (int n = 0; n < 2; ++n) *(f32x4*)(out + off + bj * HALF + n * 16) = bs[bj][n] + gv[bj][n] * acc[ai][bj][m][n];
            }
    }
};

template <class Epi, class Sched, bool ALIGN_EPI = false, bool SP2 = false>
__device__ __forceinline__ void gemm_phase(PG8_LAS unsigned char* lds, const Gemm g, const Sched& S, const Epi& E, const int tid_in) {
    const int tid = tid_in, wid = __builtin_amdgcn_readfirstlane(tid >> 6), lane = tid & 63, wr = wid >> 2, wc = wid & 3, fr = lane & 15, fq = lane >> 4;
    const int K = g.K, nt = K / BK;
    unsigned voffA[2], voffB[2];
#pragma unroll
    for (int i = 0; i < 2; ++i) { int R, C; stage_rc(tid * 16 + i * 8192, R, C); const int Rb = Epi::PERM ? ((R & ~31) + perm32(R & 31)) : R;
        voffA[i] = (unsigned)(R * K + C) * 2u; voffB[i] = (unsigned)(Rb * K + C) * 2u; }
    const size_t kstep = (size_t)(BK * 2);
    const size_t hstep = (size_t)HALF * K * 2;
    const size_t tstep = 2 * hstep;
    const unsigned ldsw = (unsigned)wid * 1024u;
    const int aoff = lds_byte(wr * 64 + fr, fq * 8), boff = lds_byte(wc * 32 + fr, fq * 8);
#define PG8_SA(b, h) (((b) * 2 + (h)) * HTB)
#define PG8_SB(b, h) ((4 + (b) * 2 + (h)) * HTB)
#define PG8_STAGE(bufoff, gbase, voff) do { _Pragma("unroll") for (int _i = 0; _i < 2; ++_i) \
        __builtin_amdgcn_global_load_lds((const unsigned*)((const char*)(gbase) + (voff)[_i]), (PG8_LAS unsigned*)(lds + (bufoff) + ldsw + _i * 8192), 16, 0, 0); } while (0)
#define PG8_LDA(dst, b, h) do { _Pragma("unroll") for (int m = 0; m < 4; ++m) _Pragma("unroll") for (int k = 0; k < 2; ++k) dst[m][k] = *(const PG8_LAS bf16x8*)(lds + PG8_SA(b, h) + aoff + m * 2048 + k * 1024); } while (0)
#define PG8_LDB(dst, b, h) do { _Pragma("unroll") for (int n = 0; n < 2; ++n) _Pragma("unroll") for (int k = 0; k < 2; ++k) dst[n][k] = *(const PG8_LAS bf16x8*)(lds + PG8_SB(b, h) + boff + n * 2048 + k * 1024); } while (0)
#define PG8_MMA(ai, bj, At, Bt) do { __builtin_amdgcn_s_setprio(1); _Pragma("unroll") for (int m = 0; m < 4; ++m) _Pragma("unroll") for (int n = 0; n < 2; ++n) _Pragma("unroll") for (int k = 0; k < 2; ++k) \
        acc[ai][bj][m][n] = __builtin_amdgcn_mfma_f32_16x16x32_bf16(Bt[n][k], At[m][k], acc[ai][bj][m][n], 0, 0, 0); __builtin_amdgcn_s_setprio(0); } while (0)
#define PG8_WAIT_V(n) asm volatile("s_waitcnt vmcnt(" #n ")" ::: "memory")
#define PG8_WAIT_L(n) asm volatile("s_waitcnt lgkmcnt(" #n ")" ::: "memory")
#define PG8_BAR __builtin_amdgcn_s_barrier()
#define PG8_SCHED __builtin_amdgcn_sched_barrier(0)
    Unit cur, nxt; int ui = 0;
    if (!S.next(0, cur)) return;
    f32x4 acc[2][2][4][2];
#pragma unroll
    for (int a = 0; a < 2; ++a)
#pragma unroll
        for (int b = 0; b < 2; ++b)
#pragma unroll
            for (int m = 0; m < 4; ++m)
#pragma unroll
                for (int n = 0; n < 2; ++n) acc[a][b][m][n] = (f32x4){0.f, 0.f, 0.f, 0.f};
    bf16x8 At[4][2], B0[2][2], B1[2][2];
    const char* cA = (const char*)g.A + (size_t)cur.pm * tstep; const char* cB = (const char*)g.Bt + (size_t)cur.pn * tstep;
    S.a_ready(cur);
    if constexpr (SP2) {
        PG8_STAGE(PG8_SB(0, 0), cB, voffB); PG8_STAGE(PG8_SB(0, 1), cB + hstep, voffB); PG8_STAGE(PG8_SA(0, 0), cA, voffA); PG8_STAGE(PG8_SA(0, 1), cA + hstep, voffA);
        if (wr == 1) PG8_BAR;
        PG8_WAIT_V(2); PG8_BAR;
        PG8_STAGE(PG8_SB(1, 0), cB + kstep, voffB); PG8_STAGE(PG8_SA(1, 0), cA + kstep, voffA); PG8_STAGE(PG8_SB(1, 1), cB + hstep + kstep, voffB);
        PG8_WAIT_V(6); PG8_BAR;
    } else {
        PG8_STAGE(PG8_SB(0, 0), cB, voffB); PG8_STAGE(PG8_SA(0, 0), cA, voffA); PG8_STAGE(PG8_SB(0, 1), cB + hstep, voffB); PG8_STAGE(PG8_SA(0, 1), cA + hstep, voffA);
        if (wr == 1) PG8_BAR;
        PG8_WAIT_V(4); PG8_BAR;
        PG8_STAGE(PG8_SB(1, 0), cB + kstep, voffB); PG8_STAGE(PG8_SA(1, 0), cA + kstep, voffA); PG8_STAGE(PG8_SB(1, 1), cB + hstep + kstep, voffB);
        PG8_WAIT_V(6); PG8_BAR;
    }
    for (;;) {
        const bool has_next = S.next(ui + 1, nxt);
        const char* nA = has_next ? (const char*)g.A + (size_t)nxt.pm * tstep : cA; const char* nB = has_next ? (const char*)g.Bt + (size_t)nxt.pn * tstep : cB;
        for (int t = 0; t < nt; t += 2) {
            const bool last = (t == nt - 2);
            const char* a1 = cA + (size_t)(t + 1) * kstep;
            const char* a2 = last ? nA : cA + (size_t)(t + 2) * kstep; const char* b2 = last ? nB : cB + (size_t)(t + 2) * kstep;
            const char* a3 = a2 + kstep; const char* b3 = b2 + kstep;
            if (last && has_next) S.a_ready(nxt);
            if constexpr (SP2) {
            PG8_LDB(B0, 0, 0); PG8_LDB(B1, 0, 1); PG8_SCHED; PG8_LDA(At, 0, 0); PG8_STAGE(PG8_SA(1, 1), a1 + hstep, voffA);
            PG8_WAIT_V(8); PG8_WAIT_L(0); PG8_BAR; PG8_MMA(0, 0, At, B0); PG8_MMA(0, 1, At, B1); PG8_BAR; PG8_SCHED;
            PG8_LDA(At, 0, 1); PG8_STAGE(PG8_SB(0, 0), b2, voffB); PG8_STAGE(PG8_SB(0, 1), b2 + hstep, voffB); PG8_STAGE(PG8_SA(0, 0), a2, voffA);
            PG8_WAIT_V(8); PG8_WAIT_L(0); PG8_BAR; PG8_MMA(1, 0, At, B0); PG8_MMA(1, 1, At, B1); PG8_BAR; PG8_SCHED;
            PG8_LDB(B0, 1, 0); PG8_LDB(B1, 1, 1); PG8_SCHED; PG8_LDA(At, 1, 0); PG8_STAGE(PG8_SA(0, 1), a2 + hstep, voffA);
            PG8_WAIT_V(8); PG8_WAIT_L(0); PG8_BAR; PG8_MMA(0, 0, At, B0); PG8_MMA(0, 1, At, B1); PG8_BAR; PG8_SCHED;
            PG8_LDA(At, 1, 1); PG8_STAGE(PG8_SB(1, 0), b3, voffB); PG8_STAGE(PG8_SB(1, 1), b3 + hstep, voffB); PG8_STAGE(PG8_SA(1, 0), a3, voffA);
            PG8_WAIT_V(8); PG8_WAIT_L(0); PG8_BAR; PG8_MMA(1, 0, At, B0); PG8_MMA(1, 1, At, B1); PG8_BAR; PG8_SCHED;
            } else {
            PG8_LDB(B0, 0, 0); PG8_SCHED; PG8_LDA(At, 0, 0); PG8_STAGE(PG8_SA(1, 1), a1 + hstep, voffA);
            PG8_WAIT_L(8); PG8_BAR; PG8_WAIT_L(0); PG8_MMA(0, 0, At, B0); PG8_BAR; PG8_SCHED;
            PG8_LDB(B1, 0, 1); PG8_STAGE(PG8_SB(0, 0), b2, voffB);
            PG8_BAR; PG8_WAIT_L(0); PG8_MMA(0, 1, At, B1); PG8_BAR;
            PG8_LDA(At, 0, 1); PG8_STAGE(PG8_SA(0, 0), a2, voffA);
            PG8_BAR; PG8_WAIT_L(0); PG8_MMA(1, 0, At, B0); PG8_BAR; PG8_SCHED;
            PG8_STAGE(PG8_SB(0, 1), b2 + hstep, voffB);
            PG8_WAIT_V(6); PG8_BAR; PG8_MMA(1, 1, At, B1); PG8_BAR;
            PG8_LDB(B0, 1, 0); PG8_SCHED; PG8_LDA(At, 1, 0); PG8_STAGE(PG8_SA(0, 1), a2 + hstep, voffA);
            PG8_WAIT_L(8); PG8_BAR; PG8_WAIT_L(0); PG8_MMA(0, 0, At, B0); PG8_BAR; PG8_SCHED;
            PG8_LDB(B1, 1, 1); PG8_STAGE(PG8_SB(1, 0), b3, voffB);
            PG8_BAR; PG8_WAIT_L(0); PG8_MMA(0, 1, At, B1); PG8_BAR;
            PG8_LDA(At, 1, 1); PG8_STAGE(PG8_SA(1, 0), a3, voffA);
            PG8_BAR; PG8_WAIT_L(0); PG8_MMA(1, 0, At, B0); PG8_BAR; PG8_SCHED;
            PG8_STAGE(PG8_SB(1, 1), b3 + hstep, voffB);
            PG8_WAIT_V(6); PG8_BAR; PG8_MMA(1, 1, At, B1); PG8_BAR;
            }
        }
        if constexpr (ALIGN_EPI) { if (wr == 0) PG8_BAR; }
        if constexpr (!Epi::AFTER_DRAIN) { E(acc, cur, wr, wc, fr, fq); S.done(cur); }
        if (!has_next) break;
#pragma unroll
        for (int a = 0; a < 2; ++a)
#pragma unroll
            for (int b = 0; b < 2; ++b)
#pragma unroll
                for (int m = 0; m < 4; ++m)
#pragma unroll
                    for (int n = 0; n < 2; ++n) acc[a][b][m][n] = (f32x4){0.f, 0.f, 0.f, 0.f};
        cur = nxt; cA = nA; cB = nB; ++ui;
        if constexpr (ALIGN_EPI) { if (wr == 1) PG8_BAR; }
    }
    PG8_WAIT_V(0);
    if constexpr (!ALIGN_EPI) { if (wr == 0) PG8_BAR; }
    PG8_BAR;
    if constexpr (Epi::AFTER_DRAIN) { E.fused(acc, cur, wr, wc, fr, fq, lds, wid, lane); S.done(cur); }
#undef PG8_SA
#undef PG8_SB
#undef PG8_STAGE
#undef PG8_LDA
#undef PG8_LDB
#undef PG8_MMA
#undef PG8_WAIT_V
#undef PG8_WAIT_L
#undef PG8_BAR
#undef PG8_SCHED
}
}

#define GAS __attribute__((address_space(1)))
#define LAS __attribute__((address_space(3)))
typedef unsigned short bf16;
typedef unsigned v4u __attribute__((ext_vector_type(4)));
typedef float f32x4 __attribute__((ext_vector_type(4)));
typedef short bf16x8 __attribute__((ext_vector_type(8)));
typedef GAS unsigned gu32;
typedef GAS unsigned long long gu64;
#define RLX_AGENT __ATOMIC_RELAXED, __HIP_MEMORY_SCOPE_AGENT
#define LDS_WAIT() asm volatile("s_waitcnt lgkmcnt(0)" ::: "memory")
#define VM_WAIT() asm volatile("s_waitcnt vmcnt(0)" ::: "memory")
__device__ __forceinline__ unsigned long long rt() { return __builtin_amdgcn_s_memrealtime(); }
__device__ __forceinline__ unsigned f2bf(float f) { unsigned u = __builtin_bit_cast(unsigned, f); return (u + 0x7fffu + ((u >> 16) & 1u)) >> 16; }
__device__ __forceinline__ unsigned pk2(float lo, float hi) { return f2bf(lo) | (f2bf(hi) << 16); }

#define XB_TMO      128
#define XB_XCNT(j)  (256  + 64 * (j))
#define XB_XSUB(j)  (1280 + 64 * (j))
#define XB_XGEN(j)  (2304 + 64 * (j))
#define XB_TOP      3328
#define XB_TOPGEN   3392
#define XCD_BAR_WORDS 3456
#define XB_SPIN_CAP (1u << 18)

__device__ __forceinline__ unsigned xb_ld(unsigned* p)              { return __hip_atomic_load(p, __ATOMIC_RELAXED, __HIP_MEMORY_SCOPE_AGENT); }
__device__ __forceinline__ unsigned xb_add(unsigned* p, unsigned v) { return __hip_atomic_fetch_add(p, v, __ATOMIC_RELAXED, __HIP_MEMORY_SCOPE_AGENT); }
__device__ __forceinline__ unsigned xb_xcc_id() { return (unsigned)__builtin_amdgcn_s_getreg((3 << 11) | 20) & 0xFu; }
#define XB_SPIN(cond, bar) do { unsigned _sp = 0; while (cond) { __builtin_amdgcn_s_sleep(1); \
    if ((++_sp & 255u) == 0u) { if (xb_ld(&(bar)[XB_TMO])) break; if (_sp > XB_SPIN_CAP) { atomicAdd(&(bar)[XB_TMO], 1u); break; } } } } while (0)

struct XcdBarrier {
    unsigned* bar; unsigned x;
    volatile LAS unsigned* st;
};

__device__ __forceinline__ XcdBarrier xcd_barrier_post(unsigned* bar, volatile LAS unsigned* st) {
    XcdBarrier b; b.bar = bar; b.x = xb_xcc_id(); b.st = st;
    if (threadIdx.x == 0) (void)xb_add(&bar[XB_XCNT(b.x)], 1u);
    return b;
}
__device__ __forceinline__ void xcd_barrier_complete(unsigned* bar, unsigned x, unsigned& nloc, unsigned& nx) {
    const unsigned G = gridDim.x * gridDim.y * gridDim.z;
    unsigned sum, cnt, mine, sp = 0u;
    for (;;) {
        sum = 0u; cnt = 0u; mine = 0u;
#pragma unroll
        for (unsigned j = 0; j < 16; ++j) { const unsigned c = xb_ld(&bar[XB_XCNT(j)]); sum += c; cnt += (c > 0u) ? 1u : 0u; mine = (j == x) ? c : mine; }
        if (sum == G) break;
        __builtin_amdgcn_s_sleep(1);
        if ((++sp & 255u) == 0u) { if (xb_ld(&bar[XB_TMO])) break; if (sp > XB_SPIN_CAP) { atomicAdd(&bar[XB_TMO], 1u); break; } }
    }
    nloc = mine > 0u ? mine : 1u; nx = cnt > 0u ? cnt : 1u;
}

__device__ __forceinline__ void xcd_barrier(const XcdBarrier& b) {
    asm volatile("s_waitcnt vmcnt(0)" ::: "memory");
    __syncthreads();
    if (threadIdx.x == 0) {
        unsigned* bar = b.bar;
        __builtin_amdgcn_s_waitcnt(0);
        unsigned nloc = b.st[0], nx = b.st[1];
        if (nloc == 0u) { xcd_barrier_complete(bar, b.x, nloc, nx); b.st[0] = nloc; b.st[1] = nx; }
        const unsigned old = xb_add(&bar[XB_XSUB(b.x)], 1u);
        const unsigned gen = old / nloc;
        if (old + 1u == (gen + 1u) * nloc) {
            __builtin_amdgcn_fence(__ATOMIC_RELEASE, "agent");
            asm volatile("s_waitcnt vmcnt(0)" ::: "memory");
            const unsigned og = xb_add(&bar[XB_TOP], 1u);
            const unsigned tg = og / nx;
            if (og + 1u == (tg + 1u) * nx) xb_add(&bar[XB_TOPGEN], 1u);
            else XB_SPIN(xb_ld(&bar[XB_TOPGEN]) == tg, bar);
            __builtin_amdgcn_fence(__ATOMIC_ACQUIRE, "agent");
            xb_add(&bar[XB_XGEN(b.x)], 1u);
            asm volatile("s_waitcnt vmcnt(0)" ::: "memory");
        } else {
            XB_SPIN(xb_ld(&bar[XB_XGEN(b.x)]) == gen, bar);
            __builtin_amdgcn_fence(__ATOMIC_ACQUIRE, "agent");
            asm volatile("s_waitcnt vmcnt(0)" ::: "memory");
        }
    }
    __syncthreads();
}

constexpr int NWAVES = 8;
constexpr int DM = 1024, NB = 4, SEQ = 4096, M = NB * SEQ;
constexpr int DFF = 2816, NFF = 2 * DFF;
constexpr int CONVW = 512, KW = 256, VW = 512, NH = 4, DK = 64, DV = 128, RANK = 16, INC = 3088, NMIX = 3072;
constexpr int CH = 64, NUNIT = M / CH;
constexpr int NADA = 9 * DM;
constexpr float EPS = 1e-6f;

constexpr size_t KiB = 1024, MiB = 1u << 20;
constexpr size_t WS_CTL = 0, CTL_ZERO_BYTES = 64 * KiB;
constexpr size_t WS_ADA = 1 * MiB;
constexpr size_t WS_WGK = 1 * MiB + 256 * KiB;
constexpr size_t WS_DEC = 1 * MiB + 512 * KiB;
constexpr size_t WS_GK = 2 * MiB;
constexpr size_t WS_W1I = 3 * MiB, WS_W1O = 14 * MiB, WS_W2I = WS_W1O + 5632 * KiB, WS_W2O = WS_W2I + 11 * MiB, WS_WMI = WS_W2O + 5632 * KiB, WS_WMO = WS_WMI + 6 * MiB;
constexpr size_t WS_XA = 44 * MiB;
constexpr size_t WS_YC = 76 * MiB;
constexpr size_t WS_BIG = 108 * MiB;
constexpr size_t WS_CB = WS_BIG, WS_U = WS_BIG + 16 * MiB, WS_QKVG = WS_BIG + 32 * MiB;
constexpr size_t WS_KD = 196 * MiB;
constexpr size_t WS_S = 228 * MiB;
constexpr size_t WS_END = 244 * MiB;
static_assert(WS_WMO + 2 * MiB == WS_XA && WS_QKVG + 48 * MiB <= WS_KD && WS_BIG + (size_t)M * DFF * 2 <= WS_KD, "ws map");
constexpr int CW_BAR = 1024;

constexpr int LDS_BYTES = 155648;
constexpr int MISC_OFF = LDS_BYTES - 256;
constexpr int L_RB = 0, VL_STRIDE = 1088, L_QH = 69632, QK_STRIDE = 576, L_KH = L_QH + 64 * QK_STRIDE, L_GK = L_KH + 64 * QK_STRIDE, L_TOT = L_GK + 4096, L_GKP = L_QH  ;
static_assert(64 * VL_STRIDE <= L_QH && L_TOT + 1024 <= MISC_OFF, "LDS map");

typedef short s16x4 __attribute__((ext_vector_type(4)));
typedef float f32x16 __attribute__((ext_vector_type(16)));
typedef unsigned v2u __attribute__((ext_vector_type(2)));

__device__ __forceinline__ float bf2f(unsigned short h) { return __builtin_bit_cast(float, (unsigned)h << 16); }
__device__ __forceinline__ float bflo(unsigned w) { return __builtin_bit_cast(float, w << 16); }
__device__ __forceinline__ float bfhi(unsigned w) { return __builtin_bit_cast(float, w & 0xffff0000u); }
__device__ __forceinline__ float wave_sum(float v) {
#pragma unroll
    for (int o = 1; o < 64; o <<= 1) v += __shfl_xor(v, o);
    return v;
}
__device__ __forceinline__ float silu(float g) { return g / (1.0f + __expf(-g)); }
__device__ __forceinline__ float logsigmoid(float z) { return fminf(z, 0.f) - log1pf(__expf(-fabsf(z))); }

struct Args {
    const float *x, *c, *w_ada, *b_ada, *norm_ffn1, *w_ffn1_in, *w_ffn1_out, *norm_mix, *w_mix_in, *conv_w, *w_gk2, *b_gk, *gla_norm, *w_mix_out, *norm_ffn2, *w_ffn2_in, *w_ffn2_out, *norm_final;
    float* out; unsigned char* ws; int ph_lo, ph_hi;
};

__device__ __forceinline__ void p0_transpose_item(const float* W, int ldw, int K, bf16* WT, int k0, int n0, int vrow0, LAS float* scr, int lane) {
#pragma unroll 8
    for (int i = 0; i < 32; ++i) { const int kk = 2 * i + (lane >> 5); scr[kk * 33 + (lane & 31)] = W[(size_t)(k0 + kk) * ldw + n0 + (lane & 31)]; }
    LDS_WAIT(); asm volatile("" ::: "memory");
    const int c = lane & 7;
#pragma unroll
    for (int j = 0; j < 4; ++j) { const int n = (lane >> 3) + 8 * j; const LAS float* s = scr + (8 * c) * 33 + n;
        v4u o; o.x = pk2(s[0 * 33], s[1 * 33]); o.y = pk2(s[2 * 33], s[3 * 33]); o.z = pk2(s[4 * 33], s[5 * 33]); o.w = pk2(s[6 * 33], s[7 * 33]);
        *(GAS v4u*)(WT + (size_t)(vrow0 + n) * K + k0 + 8 * c) = o; }
    LDS_WAIT(); asm volatile("" ::: "memory");
}
__device__ __forceinline__ int vrow_ffn_in(int n0) { return n0 < DFF ? (n0 >> 7) * 256 + (n0 & 127) : ((n0 - DFF) >> 7) * 256 + 128 + ((n0 - DFF) & 127); }
__device__ __forceinline__ int vrow_mix_in(int n0) { if (n0 < 512 || n0 >= 1536) return n0; const int a = n0 - 512; return 512 + ((a & 511) >> 7) * 256 + (a >> 9) * 128 + (a & 127); }

__device__ __forceinline__ void p0_phase(const Args& A, LAS unsigned char* lds, int vcu, int G, int tid, int lane, int wave) {
    unsigned char* ws = A.ws;
    const int bid = vcu;
    if (bid < NADA / 64) {
        LAS float* cact = (LAS float*)(lds + 69632); LAS float* part = (LAS float*)(lds + 69632 + 16384);
        for (int i = tid; i < NB * DM; i += NWAVES * 64) cact[i] = silu(A.c[i]);
        __syncthreads();
        const int cl = 4 * (lane & 15), col = 64 * bid + cl, ksub = lane >> 4;
        f32x4 a0 = {0.f, 0.f, 0.f, 0.f}, a1 = a0, a2 = a0, a3 = a0;
#pragma unroll 8
        for (int i = 0; i < 32; ++i) { const int k = 128 * wave + 4 * i + ksub; const f32x4 w4 = *(const f32x4*)(A.w_ada + (size_t)k * NADA + col);
            a0 += cact[k] * w4; a1 += cact[DM + k] * w4; a2 += cact[2 * DM + k] * w4; a3 += cact[3 * DM + k] * w4; }
#pragma unroll
        for (int e = 0; e < 4; ++e) {
            a0[e] += __shfl_xor(a0[e], 16); a0[e] += __shfl_xor(a0[e], 32); a1[e] += __shfl_xor(a1[e], 16); a1[e] += __shfl_xor(a1[e], 32);
            a2[e] += __shfl_xor(a2[e], 16); a2[e] += __shfl_xor(a2[e], 32); a3[e] += __shfl_xor(a3[e], 16); a3[e] += __shfl_xor(a3[e], 32); }
        if (ksub == 0) { *(LAS f32x4*)(part + (wave * 4 + 0) * 64 + cl) = a0; *(LAS f32x4*)(part + (wave * 4 + 1) * 64 + cl) = a1; *(LAS f32x4*)(part + (wave * 4 + 2) * 64 + cl) = a2; *(LAS f32x4*)(part + (wave * 4 + 3) * 64 + cl) = a3; }
        __syncthreads();
        if (tid < 256) { const int b = tid >> 6, cc = tid & 63; float s = 0.f;
#pragma unroll
            for (int w = 0; w < 8; ++w) s += part[(w * 4 + b) * 64 + cc];
            ((float*)(ws + WS_ADA))[b * NADA + 64 * bid + cc] = s + A.b_ada[64 * bid + cc]; }
    } else if (bid == G - 1) {
        bf16* wgk = (bf16*)(ws + WS_WGK);
        for (int i = tid; i < RANK * DM; i += NWAVES * 64) { const int j = i >> 10, k = i & 1023; wgk[j * DM + k] = (bf16)f2bf(A.w_mix_in[(size_t)k * INC + NMIX + j]); }
    }
    LAS float* scr = (LAS float*)(lds + wave * 8704);
    const int gw = vcu * NWAVES + wave, NGW = G * NWAVES;
    constexpr int I_FI = (DM / 64) * (NFF / 32), I_FO = (DFF / 64) * (DM / 32), I_MI = (DM / 64) * (NMIX / 32), I_MO = (DM / 64) * (DM / 32);
    constexpr int NITEMS = 2 * (I_FI + I_FO) + I_MI + I_MO;
    for (int it = gw; it < NITEMS; it += NGW) {
        int r = it;
        if (r < 2 * I_FI) { const int f = r >= I_FI; r -= f * I_FI; const int nblk = NFF / 32, kb = r / nblk, nb = r % nblk;
            p0_transpose_item(f ? A.w_ffn2_in : A.w_ffn1_in, NFF, DM, (bf16*)(ws + (f ? WS_W2I : WS_W1I)), 64 * kb, 32 * nb, vrow_ffn_in(32 * nb), scr, lane); continue; }
        r -= 2 * I_FI;
        if (r < 2 * I_FO) { const int f = r >= I_FO; r -= f * I_FO; const int nblk = DM / 32, kb = r / nblk, nb = r % nblk;
            p0_transpose_item(f ? A.w_ffn2_out : A.w_ffn1_out, DM, DFF, (bf16*)(ws + (f ? WS_W2O : WS_W1O)), 64 * kb, 32 * nb, 32 * nb, scr, lane); continue; }
        r -= 2 * I_FO;
        if (r < I_MI) { const int nblk = NMIX / 32, kb = r / nblk, nb = r % nblk;
            p0_transpose_item(A.w_mix_in, INC, DM, (bf16*)(ws + WS_WMI), 64 * kb, 32 * nb, vrow_mix_in(32 * nb), scr, lane); continue; }
        r -= I_MI;
        { const int nblk = DM / 32, kb = r / nblk, nb = r % nblk;
            p0_transpose_item(A.w_mix_out, DM, DM, (bf16*)(ws + WS_WMO), 64 * kb, 32 * nb, 32 * nb, scr, lane); }
    }
}

template <bool FINAL>
__device__ __forceinline__ void row_pass(const float* src, const float* gain, const float* ada, int sh_off, int sc_off, bf16* dst, float* dstf, int vcu, int G, int lane, int wave) {
    const int gw = vcu * NWAVES + wave, rpw = M / (G * NWAVES), r0 = gw * rpw, b = r0 / SEQ;
    f32x4 gs[4], sh[4];
#pragma unroll
    for (int j = 0; j < 4; ++j) { const int col = 4 * lane + 256 * j; gs[j] = *(const f32x4*)(gain + col);
        if (!FINAL) { gs[j] = gs[j] * (*(const f32x4*)(ada + b * NADA + sc_off + col) + 1.0f); sh[j] = *(const f32x4*)(ada + b * NADA + sh_off + col); } }
    for (int r = 0; r < rpw; ++r) {
        const size_t row = (size_t)(r0 + r);
        f32x4 v[4]; float ss = 0.f;
#pragma unroll
        for (int j = 0; j < 4; ++j) { v[j] = *(const f32x4*)(src + row * DM + 4 * lane + 256 * j); ss += (v[j].x * v[j].x + v[j].y * v[j].y) + (v[j].z * v[j].z + v[j].w * v[j].w); }
        const float rstd = 1.0f / sqrtf(wave_sum(ss) * (1.0f / DM) + EPS);
#pragma unroll
        for (int j = 0; j < 4; ++j) {
            if (FINAL) { *(f32x4*)(dstf + row * DM + 4 * lane + 256 * j) = v[j] * rstd * gs[j]; }
            else { const f32x4 o = v[j] * rstd * gs[j] + sh[j]; v2u w; w.x = pk2(o.x, o.y); w.y = pk2(o.z, o.w); *(v2u*)(dst + row * DM + 4 * lane + 256 * j) = w; }
        }
    }
}

__device__ __forceinline__ bf16x8 tr_frag(LAS unsigned char* base, int off0, int off1) {
    const s16x4 a = __builtin_amdgcn_ds_read_tr16_b64_v4i16((LAS s16x4*)(base + off0));
    const s16x4 b = __builtin_amdgcn_ds_read_tr16_b64_v4i16((LAS s16x4*)(base + off1));
    bf16x8 r; r[0] = a[0]; r[1] = a[1]; r[2] = a[2]; r[3] = a[3]; r[4] = b[0]; r[5] = b[1]; r[6] = b[2]; r[7] = b[3]; return r;
}
__device__ __forceinline__ void compute_b(const Args& A, LAS float* gk, LAS float* bb, LAS float* tot, int tid) {
    const int col = tid & 255, th = tid >> 8;
    float w[16];
#pragma unroll
    for (int r = 0; r < 16; ++r) w[r] = A.w_gk2[r * KW + col];
    const float bias = A.b_gk[col];
    float run = 0.f;
    for (int tt = 0; tt < 32; ++tt) {
        const int t = 32 * th + tt; float z = bias;
#pragma unroll
        for (int r4 = 0; r4 < 4; ++r4) { const f32x4 g = *(const LAS f32x4*)(gk + t * 16 + 4 * r4); z += g[0] * w[4 * r4] + g[1] * w[4 * r4 + 1] + g[2] * w[4 * r4 + 2] + g[3] * w[4 * r4 + 3]; }
        run += logsigmoid(z) * (1.0f / 16.0f);
        bb[t * 256 + col] = run;
    }
    if (th == 0) tot[col] = run;
    __syncthreads();
    if (th == 1) { const float o = tot[col];
        for (int tt = 0; tt < 32; ++tt) bb[(32 + tt) * 256 + col] += o; }
    __syncthreads();
}

__device__ __forceinline__ void gla_a_phase(const Args& A, LAS unsigned char* lds, int unit, int tid, int lane, int wave) {
    unsigned char* ws = A.ws;
    const bf16* CB = (const bf16*)(ws + WS_CB); const bf16* U = (const bf16*)(ws + WS_U); const bf16* QKVG = (const bf16*)(ws + WS_QKVG); const bf16* XA = (const bf16*)(ws + WS_XA);
    bf16* YC = (bf16*)(ws + WS_YC);
    const int row0 = unit * CH;
    {
        const int ch0 = 8 * (tid & 63), r0 = row0 + 8 * (tid >> 6);
        float w0[8], w1[8], w2[8];
#pragma unroll
        for (int e = 0; e < 8; ++e) { w0[e] = A.conv_w[ch0 + e]; w1[e] = A.conv_w[CONVW + ch0 + e]; w2[e] = A.conv_w[2 * CONVW + ch0 + e]; }
        const bool head = (r0 & (SEQ - 1)) == 0;
        v4u um2 = {0u, 0u, 0u, 0u}, um1 = um2;
        if (!head) { um2 = *(const v4u*)(U + (size_t)(r0 - 2) * CONVW + ch0); um1 = *(const v4u*)(U + (size_t)(r0 - 1) * CONVW + ch0); }
#pragma unroll 4
        for (int i = 0; i < 8; ++i) {
            const v4u u0 = *(const v4u*)(U + (size_t)(r0 + i) * CONVW + ch0), cb = *(const v4u*)(CB + (size_t)(r0 + i) * CONVW + ch0);
            v4u o;
#pragma unroll
            for (int q = 0; q < 4; ++q) {
                const float ylo = bflo(cb[q]) * (w0[2 * q] * bflo(um2[q]) + w1[2 * q] * bflo(um1[q]) + w2[2 * q] * bflo(u0[q]));
                const float yhi = bfhi(cb[q]) * (w0[2 * q + 1] * bfhi(um2[q]) + w1[2 * q + 1] * bfhi(um1[q]) + w2[2 * q + 1] * bfhi(u0[q]));
                o[q] = pk2(ylo, yhi);
            }
            *(v4u*)(YC + (size_t)(r0 + i) * DM + ch0) = o;
            um2 = um1; um1 = u0;
        }
    }
    LAS float* gk = (LAS float*)(lds + L_GK); LAS float* gkp = (LAS float*)(lds + L_GKP); LAS float* tot = (LAS float*)(lds + L_TOT); LAS float* bb = (LAS float*)(lds + L_RB);
    {
        const int rb = wave & 3, kh = wave >> 2;
        const bf16* arow = XA + (size_t)(row0 + 16 * rb + (lane & 15)) * DM + kh * 512 + 8 * (lane >> 4);
        const bf16* brow = (const bf16*)(ws + WS_WGK) + (size_t)(lane & 15) * DM + kh * 512 + 8 * (lane >> 4);
        f32x4 d = {0.f, 0.f, 0.f, 0.f};
#pragma unroll 4
        for (int ks = 0; ks < 16; ++ks) { const bf16x8 a = *(const bf16x8*)(arow + 32 * ks), b = *(const bf16x8*)(brow + 32 * ks); d = __builtin_amdgcn_mfma_f32_16x16x32_bf16(a, b, d, 0, 0, 0); }
#pragma unroll
        for (int r = 0; r < 4; ++r) gkp[(kh * 64 + 16 * rb + 4 * (lane >> 4) + r) * 16 + (lane & 15)] = d[r];
    }
    __syncthreads();
    for (int i = tid; i < CH * RANK; i += NWAVES * 64) { const float g = gkp[i] + gkp[CH * RANK + i]; gk[i] = g; ((float*)(ws + WS_GK))[(size_t)unit * (CH * RANK) + i] = g; }
    __syncthreads();
    compute_b(A, gk, bb, tot, tid);
    v4u vreg[8];
#pragma unroll
    for (int i = 0; i < 8; ++i) { const int idx = tid + 512 * i, t = idx >> 6, c8 = idx & 63; vreg[i] = *(const v4u*)(QKVG + (size_t)(row0 + t) * 1536 + 512 + 8 * c8); }
#pragma unroll
    for (int i = 0; i < 4; ++i) {
        const int idx = tid + 512 * i, t = idx >> 5, c8 = idx & 31;
        const v4u kk = *(const v4u*)(QKVG + (size_t)(row0 + t) * 1536 + 256 + 8 * c8);
        const f32x4 bl0 = *(const LAS f32x4*)(bb + 63 * 256 + 8 * c8), bl1 = *(const LAS f32x4*)(bb + 63 * 256 + 8 * c8 + 4);
        const f32x4 b0 = *(const LAS f32x4*)(bb + t * 256 + 8 * c8), b1 = *(const LAS f32x4*)(bb + t * 256 + 8 * c8 + 4);
        v4u o;
        o.x = pk2(bflo(kk.x) * __expf(bl0[0] - b0[0]), bfhi(kk.x) * __expf(bl0[1] - b0[1]));
        o.y = pk2(bflo(kk.y) * __expf(bl0[2] - b0[2]), bfhi(kk.y) * __expf(bl0[3] - b0[3]));
        o.z = pk2(bflo(kk.z) * __expf(bl1[0] - b1[0]), bfhi(kk.z) * __expf(bl1[1] - b1[1]));
        o.w = pk2(bflo(kk.w) * __expf(bl1[2] - b1[2]), bfhi(kk.w) * __expf(bl1[3] - b1[3]));
        *(LAS v4u*)(lds + L_KH + t * QK_STRIDE + 16 * c8) = o;
    }
    if (tid < 256) ((float*)(ws + WS_DEC))[unit * 256 + tid] = __expf(bb[63 * 256 + tid]);
    __syncthreads();
#pragma unroll
    for (int i = 0; i < 8; ++i) { const int idx = tid + 512 * i, t = idx >> 6, c8 = idx & 63; *(LAS v4u*)(lds + L_RB + t * VL_STRIDE + 16 * c8) = vreg[i]; }
    __syncthreads();
    {
        const int h = wave >> 1, dvh = wave & 1, hb = lane >> 5, blk = (lane >> 4) & 1, q = (lane & 15) >> 2, p = lane & 3;
        f32x16 acc[2][2];
#pragma unroll
        for (int a = 0; a < 2; ++a)
#pragma unroll
            for (int b = 0; b < 2; ++b)
#pragma unroll
                for (int e = 0; e < 16; ++e) acc[a][b][e] = 0.f;
#pragma unroll
        for (int ks = 0; ks < 4; ++ks) {
            const int trow = 16 * ks + 8 * hb + q;
            bf16x8 af[2], bf[2];
#pragma unroll
            for (int mt = 0; mt < 2; ++mt) { const int cb = (h * 128 + dvh * 64 + 32 * mt + 16 * blk + 4 * p) * 2; af[mt] = tr_frag(lds + L_RB, trow * VL_STRIDE + cb, (trow + 4) * VL_STRIDE + cb); }
#pragma unroll
            for (int nt = 0; nt < 2; ++nt) { const int cb = (h * 64 + 32 * nt + 16 * blk + 4 * p) * 2; bf[nt] = tr_frag(lds + L_KH, trow * QK_STRIDE + cb, (trow + 4) * QK_STRIDE + cb); }
#pragma unroll
            for (int mt = 0; mt < 2; ++mt)
#pragma unroll
                for (int nt = 0; nt < 2; ++nt) acc[mt][nt] = __builtin_amdgcn_mfma_f32_32x32x16_bf16(af[mt], bf[nt], acc[mt][nt], 0, 0, 0);
        }
        float* KD = (float*)(ws + WS_KD) + ((size_t)(unit * NH + h) * DV) * DK;
#pragma unroll
        for (int mt = 0; mt < 2; ++mt)
#pragma unroll
            for (int nt = 0; nt < 2; ++nt)
#pragma unroll
                for (int e = 0; e < 16; ++e) { const int dv = dvh * 64 + 32 * mt + (e & 3) + 8 * (e >> 2) + 4 * hb, dk = 32 * nt + (lane & 31); KD[dv * DK + dk] = acc[mt][nt][e]; }
    }
    __syncthreads();
}

__device__ __forceinline__ void gla_scan_phase(const Args& A, int vcu, int G, int tid) {
    unsigned char* ws = A.ws;
    const float* KD = (const float*)(ws + WS_KD); const float* DEC = (const float*)(ws + WS_DEC); bf16* S = (bf16*)(ws + WS_S);
    { const int e = vcu * (NWAVES * 64) + tid;
        const int b = e >> 15, rem = e & 32767, dcol = (rem >> 13) * 64 + (rem & 63);
        float s = 0.f;
#pragma unroll 16
        for (int c = 0; c < SEQ / CH; ++c) {
            const int unit = b * (SEQ / CH) + c; const size_t off = (size_t)unit * 32768 + rem;
            S[off] = (bf16)f2bf(s);
            s = DEC[unit * 256 + dcol] * s + KD[off];
        }
    }
}

__device__ __forceinline__ void gla_c_phase(const Args& A, LAS unsigned char* lds, int unit, int tid, int lane, int wave) {
    unsigned char* ws = A.ws;
    const bf16* QKVG = (const bf16*)(ws + WS_QKVG); bf16* YC = (bf16*)(ws + WS_YC);
    const int row0 = unit * CH;
    LAS float* gk = (LAS float*)(lds + L_GK); LAS float* tot = (LAS float*)(lds + L_TOT); LAS float* bb = (LAS float*)(lds + L_RB);
    for (int i = tid; i < CH * RANK; i += NWAVES * 64) gk[i] = ((const float*)(ws + WS_GK))[(size_t)unit * (CH * RANK) + i];
    __syncthreads();
    compute_b(A, gk, bb, tot, tid);
    v4u vreg[8];
#pragma unroll
    for (int i = 0; i < 8; ++i) { const int idx = tid + 512 * i, t = idx >> 6, c8 = idx & 63; vreg[i] = *(const v4u*)(QKVG + (size_t)(row0 + t) * 1536 + 512 + 8 * c8); }
#pragma unroll
    for (int i = 0; i < 4; ++i) {
        const int idx = tid + 512 * i, t = idx >> 5, c8 = idx & 31;
        const v4u qq = *(const v4u*)(QKVG + (size_t)(row0 + t) * 1536 + 8 * c8), kk = *(const v4u*)(QKVG + (size_t)(row0 + t) * 1536 + 256 + 8 * c8);
        const f32x4 b0 = *(const LAS f32x4*)(bb + t * 256 + 8 * c8), b1 = *(const LAS f32x4*)(bb + t * 256 + 8 * c8 + 4);
        float ep[8], en[8];
#pragma unroll
        for (int e = 0; e < 4; ++e) { ep[e] = 0.125f * __expf(b0[e]); en[e] = __expf(-b0[e]); ep[4 + e] = 0.125f * __expf(b1[e]); en[4 + e] = __expf(-b1[e]); }
        v4u oq, ok;
        oq.x = pk2(bflo(qq.x) * ep[0], bfhi(qq.x) * ep[1]); oq.y = pk2(bflo(qq.y) * ep[2], bfhi(qq.y) * ep[3]); oq.z = pk2(bflo(qq.z) * ep[4], bfhi(qq.z) * ep[5]); oq.w = pk2(bflo(qq.w) * ep[6], bfhi(qq.w) * ep[7]);
        ok.x = pk2(bflo(kk.x) * en[0], bfhi(kk.x) * en[1]); ok.y = pk2(bflo(kk.y) * en[2], bfhi(kk.y) * en[3]); ok.z = pk2(bflo(kk.z) * en[4], bfhi(kk.z) * en[5]); ok.w = pk2(bflo(kk.w) * en[6], bfhi(kk.w) * en[7]);
        *(LAS v4u*)(lds + L_QH + t * QK_STRIDE + 16 * c8) = oq;
        *(LAS v4u*)(lds + L_KH + t * QK_STRIDE + 16 * c8) = ok;
    }
    __syncthreads();
#pragma unroll
    for (int i = 0; i < 8; ++i) { const int idx = tid + 512 * i, t = idx >> 6, c8 = idx & 63; *(LAS v4u*)(lds + L_RB + t * VL_STRIDE + 16 * c8) = vreg[i]; }
    __syncthreads();
    {
        const int h = wave >> 1, ih = wave & 1, hb = lane >> 5, r = lane & 31, blk = (lane >> 4) & 1, q = (lane & 15) >> 2, p = lane & 3;
        bf16x8 qf[4];
#pragma unroll
        for (int ks = 0; ks < 4; ++ks) qf[ks] = *(const LAS bf16x8*)(lds + L_QH + (32 * ih + r) * QK_STRIDE + (h * 64 + 16 * ks + 8 * hb) * 2);
        bf16x8 pb[2][2];
#pragma unroll
        for (int jt = 0; jt < 2; ++jt) {
            f32x16 x;
#pragma unroll
            for (int e = 0; e < 16; ++e) x[e] = 0.f;
            if (jt <= ih) {
#pragma unroll
                for (int ks = 0; ks < 4; ++ks) { const bf16x8 kf = *(const LAS bf16x8*)(lds + L_KH + (32 * jt + r) * QK_STRIDE + (h * 64 + 16 * ks + 8 * hb) * 2); x = __builtin_amdgcn_mfma_f32_32x32x16_bf16(kf, qf[ks], x, 0, 0, 0); }
                if (jt == ih) {
#pragma unroll
                    for (int e = 0; e < 16; ++e) { const int jl = (e & 3) + 8 * (e >> 2) + 4 * hb; if (jl > r) x[e] = 0.f; }
                }
            }
#pragma unroll
            for (int s = 0; s < 2; ++s) { v4u w; w.x = pg8::cvt_pk_bf16(x[8 * s + 0], x[8 * s + 1]); w.y = pg8::cvt_pk_bf16(x[8 * s + 2], x[8 * s + 3]); w.z = pg8::cvt_pk_bf16(x[8 * s + 4], x[8 * s + 5]); w.w = pg8::cvt_pk_bf16(x[8 * s + 6], x[8 * s + 7]); pb[jt][s] = __builtin_bit_cast(bf16x8, w); }
        }
        f32x16 acc[4];
#pragma unroll
        for (int mt = 0; mt < 4; ++mt)
#pragma unroll
            for (int e = 0; e < 16; ++e) acc[mt][e] = 0.f;
        const bf16* Sg = (const bf16*)(ws + WS_S) + ((size_t)(unit * NH + h) * DV) * DK;
#pragma unroll
        for (int ks = 0; ks < 4; ++ks)
#pragma unroll
            for (int mt = 0; mt < 4; ++mt) { const bf16x8 sf = *(const bf16x8*)(Sg + (size_t)(32 * mt + r) * DK + 16 * ks + 8 * hb); acc[mt] = __builtin_amdgcn_mfma_f32_32x32x16_bf16(sf, qf[ks], acc[mt], 0, 0, 0); }
#pragma unroll
        for (int jt = 0; jt < 2; ++jt) {
            if (jt <= ih) {
#pragma unroll
                for (int s = 0; s < 2; ++s) {
                    const int trow = 32 * jt + 16 * s + 4 * hb + q;
#pragma unroll
                    for (int mt = 0; mt < 4; ++mt) { const int cb = (h * 128 + 32 * mt + 16 * blk + 4 * p) * 2; const bf16x8 vf = tr_frag(lds + L_RB, trow * VL_STRIDE + cb, (trow + 8) * VL_STRIDE + cb); acc[mt] = __builtin_amdgcn_mfma_f32_32x32x16_bf16(vf, pb[jt][s], acc[mt], 0, 0, 0); }
                }
            }
        }
        float ss = 0.f;
#pragma unroll
        for (int mt = 0; mt < 4; ++mt)
#pragma unroll
            for (int e = 0; e < 16; ++e) ss += acc[mt][e] * acc[mt][e];
        ss += __shfl_xor(ss, 32);
        const float rstd = 1.0f / sqrtf(ss * (1.0f / DV) + EPS);
        const size_t row = (size_t)(row0 + 32 * ih + r);
#pragma unroll
        for (int mt = 0; mt < 4; ++mt)
#pragma unroll
            for (int rq = 0; rq < 4; ++rq) {
                const int dv0 = 32 * mt + 8 * rq + 4 * hb;
                const v2u g = *(const v2u*)(QKVG + row * 1536 + 1024 + h * DV + dv0);
                const f32x4 n4 = *(const f32x4*)(A.gla_norm + dv0);
                v2u o;
                o.x = pk2(acc[mt][4 * rq + 0] * rstd * n4[0] * silu(bflo(g.x)), acc[mt][4 * rq + 1] * rstd * n4[1] * silu(bfhi(g.x)));
                o.y = pk2(acc[mt][4 * rq + 2] * rstd * n4[2] * silu(bflo(g.y)), acc[mt][4 * rq + 3] * rstd * n4[3] * silu(bfhi(g.y)));
                *(v2u*)(YC + row * DM + CONVW + h * DV + dv0) = o;
            }
    }
    __syncthreads();
}

constexpr int NPH = 14;
#ifndef MK_N_LAUNCHES
#define MK_N_LAUNCHES 14
#endif
__global__ void __launch_bounds__(NWAVES * 64, 2) mk_fwd(Args args) {
    extern __shared__ __attribute__((aligned(16))) unsigned char lds_raw[];
    LAS unsigned char* lds = (LAS unsigned char*)lds_raw;
    volatile LAS unsigned* MISC = (volatile LAS unsigned*)(lds + MISC_OFF);
    const int G = gridDim.x;
    unsigned char* ws = args.ws;
    if (threadIdx.x < 64) MISC[threadIdx.x] = 0u;
    __syncthreads();
    XcdBarrier bar; bar.bar = (unsigned*)(ws + WS_CTL) + CW_BAR; bar.x = 0; bar.st = nullptr;
    if (MK_N_LAUNCHES == 1) bar = xcd_barrier_post((unsigned*)(ws + WS_CTL) + CW_BAR, MISC + 8);
    const float* ADA = (const float*)(ws + WS_ADA);
    bf16* XA = (bf16*)(ws + WS_XA);
    const int lo = args.ph_lo, hi = args.ph_hi;
    const int tid = threadIdx.x, bx = blockIdx.x;
    const int lane = tid & 63, wave = __builtin_amdgcn_readfirstlane(tid >> 6), vcu = (G % 8 == 0) ? (bx % 8) * (G / 8) + bx / 8 : bx;
#define IN(k) (lo <= (k) && (k) < hi)
#define SEAM(k) do { if ((k) + 1 < hi) xcd_barrier(bar); } while (0)
#define ROWPASS(k, src, gain, so) if (IN(k)) { row_pass<false>(src, gain, ADA, so, (so) + DM, XA, nullptr, vcu, G, lane, wave); SEAM(k); }
#define FFN_IN(k, wsoff) if (IN(k)) { pg8::Gemm g{(const pg8::bf16_t*)XA, (const pg8::bf16_t*)(ws + (wsoff)), M, NFF, DM}; pg8::StaticOrder S; S.init(M, NFF, G, bx); \
        pg8::EpiSwiglu E{(pg8::bf16_t*)(ws + WS_BIG), DFF}; pg8::gemm_phase<pg8::EpiSwiglu, pg8::StaticOrder, true, true>(lds, g, S, E, tid); SEAM(k); }
#define RES_GEMM(k, aoff, woff, KK, basep, goff, sc) if (IN(k)) { pg8::Gemm g{(const pg8::bf16_t*)(ws + (aoff)), (const pg8::bf16_t*)(ws + (woff)), M, DM, KK}; pg8::StaticOrder S; S.init(M, DM, G, bx); \
        pg8::EpiRes E{basep, args.out, ADA + (goff), NADA, sc}; pg8::gemm_phase<pg8::EpiRes, pg8::StaticOrder, false, true>(lds, g, S, E, tid); SEAM(k); }
    if (IN(0)) { p0_phase(args, lds, vcu, G, tid, lane, wave); SEAM(0); }
    ROWPASS(1, args.x, args.norm_ffn1, 0)
    FFN_IN(2, WS_W1I)
    RES_GEMM(3, WS_BIG, WS_W1O, DFF, args.x, 2 * DM, 0.5f)
    ROWPASS(4, args.out, args.norm_mix, 3 * DM)
    if (IN(5)) { pg8::Gemm g{(const pg8::bf16_t*)XA, (const pg8::bf16_t*)(ws + WS_WMI), M, NMIX, DM}; pg8::StaticOrder S; S.init(M, NMIX, G, bx);
        pg8::EpiMix E{(pg8::bf16_t*)(ws + WS_CB), (pg8::bf16_t*)(ws + WS_U), (pg8::bf16_t*)(ws + WS_QKVG)};
        pg8::gemm_phase<pg8::EpiMix, pg8::StaticOrder, true, true>(lds, g, S, E, tid); SEAM(5); }
    if (IN(6)) { if (vcu < NUNIT) gla_a_phase(args, lds, vcu, tid, lane, wave);     SEAM(6); }
    if (IN(7)) { gla_scan_phase(args, vcu, G, tid); SEAM(7); }
    if (IN(8)) { if (vcu < NUNIT) gla_c_phase(args, lds, vcu, tid, lane, wave); SEAM(8); }
    RES_GEMM(9, WS_YC, WS_WMO, DM, args.out, 5 * DM, 1.0f)
    ROWPASS(10, args.out, args.norm_ffn2, 6 * DM)
    FFN_IN(11, WS_W2I)
    RES_GEMM(12, WS_BIG, WS_W2O, DFF, args.out, 8 * DM, 0.5f)
    if (IN(13)) row_pass<true>(args.out, args.norm_final, nullptr, 0, 0, nullptr, args.out, vcu, G, lane, wave);
#undef IN
#undef SEAM
#undef ROWPASS
#undef FFN_IN
#undef RES_GEMM
}

extern "C" void kernel_launch(void* const* d_in, const int* in_sizes, int n_in, void* d_out, int out_size, void* d_ws, size_t ws_size, hipStream_t stream) {
    static int grid = 0;
    if (grid == 0) {
        if (n_in != 18 || in_sizes[0] != M * DM || out_size != M * DM || ws_size < WS_END) { fprintf(stderr, "kernel_launch: unexpected shapes (n_in %d, in0 %d, out %d, ws %zu); nothing launched\n", n_in, n_in > 0 ? in_sizes[0] : -1, out_size, ws_size); grid = -1; return; }
        int dev = 0, cus = 0, per_cu = 0;
        if (hipGetDevice(&dev) != hipSuccess || hipDeviceGetAttribute(&cus, hipDeviceAttributeMultiprocessorCount, dev) != hipSuccess) { grid = -1; return; }
        if (hipFuncSetAttribute((const void*)mk_fwd, hipFuncAttributeMaxDynamicSharedMemorySize, LDS_BYTES) != hipSuccess) { fprintf(stderr, "kernel_launch: hipFuncSetAttribute failed\n"); grid = -1; return; }
        if (hipOccupancyMaxActiveBlocksPerMultiprocessor(&per_cu, (const void*)mk_fwd, NWAVES * 64, LDS_BYTES) != hipSuccess || per_cu < 1) fprintf(stderr, "kernel_launch: note: occupancy query reports %d\n", per_cu);
        (void)hipGetLastError();
        grid = 256;
        if (cus < 256) { fprintf(stderr, "kernel_launch: device has %d CUs, need 256; nothing launched\n", cus); grid = -1; return; }
    }
    if (grid < 0) return;
    if (hipMemsetAsync((char*)d_ws + WS_CTL, 0, CTL_ZERO_BYTES, stream) != hipSuccess) return;
    Args a{};
    const float** ap = (const float**)&a;
    for (int i = 0; i < 18; ++i) ap[i] = (const float*)d_in[i];
    a.out = (float*)d_out; a.ws = (unsigned char*)d_ws;
    if (MK_N_LAUNCHES == 1) { a.ph_lo = 0; a.ph_hi = NPH; hipLaunchKernelGGL(mk_fwd, dim3(grid), dim3(NWAVES * 64), LDS_BYTES, stream, a); }
    else for (int p = 0; p < NPH; ++p) { a.ph_lo = p; a.ph_hi = p + 1; hipLaunchKernelGGL(mk_fwd, dim3(grid), dim3(NWAVES * 64), LDS_BYTES, stream, a); }
}
```
